# Optimizing an MI355X kernel written in HIP

```python
import math
import jax, jax.numpy as jnp
from jax import lax
import numpy as np

D_MODEL = 1024
BATCH = 8
SEQ = 2048
DEPTH = 1

CHUNK = 64
Q_BLOCK = 128
MEM_LEN = 256
POOL_WIDTH = D_MODEL
POOL_WINDOWS = (2, 4, 8, 16)
POOL_GROUPS = len(POOL_WINDOWS)
POOL_GROUP_DIM = POOL_WIDTH // POOL_GROUPS
DIFF_HEADS = 8
DIFF_HEAD_DIM = 64
DIFF_WIDTH = DIFF_HEADS * 2 * DIFF_HEAD_DIM
LAMBDA_INIT_BASE = 0.8
LAMBDA_INIT_AMP = 0.6
LAMBDA_INIT_RATE = 0.3
REL_BUCKETS = 32
REL_MAX_DIST = 128
CROSS_HEADS = 4
CROSS_HEAD_DIM = D_MODEL // CROSS_HEADS
D_FF = 4 * D_MODEL
IN_WIDTH = POOL_WIDTH + 3 * DIFF_WIDTH
EPS = 1e-6
NEG_INF = -1e30

kernel_name = "hybrid_pool_diffattn_gated_encoder"


def rmsnorm(x, g):
    xf = x.astype(jnp.float32)
    y = xf * lax.rsqrt(jnp.mean(xf * xf, axis=-1, keepdims=True) + EPS)
    return (y * g.astype(jnp.float32)).astype(x.dtype)


def multiscale_pool(u, w_group, scale):
    B, S, _ = u.shape
    uf = u.reshape(B, S, POOL_GROUPS, POOL_GROUP_DIM).astype(jnp.float32)
    cs = jnp.concatenate([jnp.zeros_like(uf[:, :1]), jnp.cumsum(uf, axis=1)], axis=1)
    t = jnp.arange(S)
    outs = []
    for g, w in enumerate(POOL_WINDOWS):
        c = cs[:, :, g]
        hi = c[:, 1:]
        lo = jnp.pad(c, ((0, 0), (w - 1, 0), (0, 0)))[:, :S]
        count = jnp.minimum(t + 1, w).astype(jnp.float32)[None, :, None]
        outs.append((hi - lo) / count - uf[:, :, g])
    pooled = jnp.stack(outs, axis=2).astype(u.dtype)
    y = jnp.einsum('bsgc,gcd->bsgd', pooled, w_group).reshape(B, S, POOL_WIDTH)
    return y * scale


def t5_bucket(rel):
    nb = REL_BUCKETS // 2
    ret = (rel > 0).astype(jnp.int32) * nb
    n = jnp.abs(rel)
    max_exact = nb // 2
    nf = jnp.maximum(n, 1).astype(jnp.float32)
    large = max_exact + (jnp.log(nf / max_exact) / math.log(REL_MAX_DIST / max_exact)
                         * (nb - max_exact)).astype(jnp.int32)
    large = jnp.minimum(large, nb - 1)
    return ret + jnp.where(n < max_exact, n, large)


def diff_attention(q, k, v, rel_bias, lam, lambda_init, subln_g):
    B, S = q.shape[:2]
    scale = DIFF_HEAD_DIM ** -0.5
    pos = jnp.arange(S, dtype=jnp.int32)
    outs = []
    for blk in range(S // Q_BLOCK):
        q0 = blk * Q_BLOCK
        kl = q0 + Q_BLOCK
        qp, kp = pos[q0:kl], pos[:kl]
        s = jnp.einsum('bqhmd,bkhmd->bhmqk', q[:, q0:kl], k[:, :kl]).astype(jnp.float32) * scale
        bias = jnp.transpose(rel_bias[t5_bucket(kp[None, :] - qp[:, None])], (2, 0, 1))
        s = s + bias[None, :, None].astype(jnp.float32)
        allowed = (kp[None, :] // CHUNK) <= (qp[:, None] // CHUNK)
        s = jnp.where(allowed, s, NEG_INF)
        p = jax.nn.softmax(s, axis=-1)
        a = p[:, :, 0] - lam * p[:, :, 1]
        outs.append(jnp.einsum('bhqk,bkhe->bqhe', a.astype(v.dtype), v[:, :kl]))
    o = jnp.concatenate(outs, axis=1)
    o = rmsnorm(o, subln_g) * (1.0 - lambda_init)
    return o.reshape(B, S, DIFF_WIDTH)


def cross_attention(hn, mn, w_cq, w_ckv, w_co):
    B, S, _ = hn.shape
    M = mn.shape[1]
    cq = (hn @ w_cq).reshape(B, S, CROSS_HEADS, CROSS_HEAD_DIM)
    ckv = (mn @ w_ckv).reshape(B, M, 2, CROSS_HEADS, CROSS_HEAD_DIM)
    ck, cv = ckv[:, :, 0], ckv[:, :, 1]
    s = jnp.einsum('bshd,bmhd->bhsm', cq, ck).astype(jnp.float32) * (CROSS_HEAD_DIM ** -0.5)
    p = jax.nn.softmax(s, axis=-1).astype(cv.dtype)
    o = jnp.einsum('bhsm,bmhd->bshd', p, cv).reshape(B, S, D_MODEL)
    return o @ w_co


def setup_inputs(seed: int = 0) -> dict:
    key = jax.random.key(seed)
    ks = jax.random.split(key, 32)
    f32 = jnp.float32

    def nrm(k, shape, fan_in):
        return jax.random.normal(k, shape, f32) * (fan_in ** -0.5)

    def gain(k, shape):
        return 1.0 + 0.05 * jax.random.normal(k, shape, f32)

    L = DEPTH
    return {
        "x": jax.random.normal(ks[0], (BATCH, SEQ, D_MODEL), f32),
        "mem": jax.random.normal(ks[1], (BATCH, MEM_LEN, D_MODEL), f32),
        "norm_mix_g": gain(ks[2], (L, D_MODEL)),
        "w_in": nrm(ks[3], (L, D_MODEL, IN_WIDTH), D_MODEL),
        "w_pool_group": nrm(ks[4], (L, POOL_GROUPS, POOL_GROUP_DIM, POOL_GROUP_DIM), POOL_GROUP_DIM),
        "pool_scale": gain(ks[5], (L, POOL_WIDTH)),
        "w_a_proj": nrm(ks[6], (L, POOL_WIDTH, D_MODEL), POOL_WIDTH),
        "lambda_q1": 0.1 * jax.random.normal(ks[7], (L, DIFF_HEAD_DIM), f32),
        "lambda_k1": 0.1 * jax.random.normal(ks[8], (L, DIFF_HEAD_DIM), f32),
        "lambda_q2": 0.1 * jax.random.normal(ks[9], (L, DIFF_HEAD_DIM), f32),
        "lambda_k2": 0.1 * jax.random.normal(ks[10], (L, DIFF_HEAD_DIM), f32),
        "subln_g": gain(ks[11], (L, 2 * DIFF_HEAD_DIM)),
        "rel_bias": 0.1 * jax.random.normal(ks[12], (REL_BUCKETS, DIFF_HEADS), f32),
        "w_b_proj": nrm(ks[13], (L, DIFF_WIDTH, D_MODEL), DIFF_WIDTH),
        "w_gate": nrm(ks[14], (L, D_MODEL, 2 * D_MODEL), D_MODEL),
        "b_gate": 0.01 * jax.random.normal(ks[15], (L, 2 * D_MODEL), f32),
        "w_out": nrm(ks[16], (L, D_MODEL, D_MODEL), D_MODEL),
        "norm_cross_g": gain(ks[17], (L, D_MODEL)),
        "norm_mem_g": gain(ks[18], (L, D_MODEL)),
        "w_cq": nrm(ks[19], (L, D_MODEL, D_MODEL), D_MODEL),
        "w_ckv": nrm(ks[20], (L, D_MODEL, 2 * D_MODEL), D_MODEL),
        "w_co": nrm(ks[21], (L, D_MODEL, D_MODEL), D_MODEL),
        "norm_mlp_g": gain(ks[22], (L, D_MODEL)),
        "w_ff1": nrm(ks[23], (L, D_MODEL, D_FF), D_MODEL),
        "w_ff2": nrm(ks[24], (L, D_FF, D_MODEL), D_FF),
        "final_norm_g": gain(ks[25], (D_MODEL,)),
    }


def reference(x, mem, norm_mix_g, w_in, w_pool_group, pool_scale, w_a_proj,
              lambda_q1, lambda_k1, lambda_q2, lambda_k2, subln_g, rel_bias, w_b_proj,
              w_gate, b_gate, w_out, norm_cross_g, norm_mem_g, w_cq, w_ckv, w_co,
              norm_mlp_g, w_ff1, w_ff2, final_norm_g):
    B, S, _ = x.shape
    h = x
    for l in range(DEPTH):
        xn = rmsnorm(h, norm_mix_g[l])
        proj = xn @ w_in[l]
        u = proj[..., :POOL_WIDTH]
        q = proj[..., POOL_WIDTH:POOL_WIDTH + DIFF_WIDTH].reshape(B, S, DIFF_HEADS, 2, DIFF_HEAD_DIM)
        k = proj[..., POOL_WIDTH + DIFF_WIDTH:POOL_WIDTH + 2 * DIFF_WIDTH].reshape(
            B, S, DIFF_HEADS, 2, DIFF_HEAD_DIM)
        v = proj[..., POOL_WIDTH + 2 * DIFF_WIDTH:].reshape(B, S, DIFF_HEADS, 2 * DIFF_HEAD_DIM)

        y_a = multiscale_pool(u, w_pool_group[l], pool_scale[l]) @ w_a_proj[l]

        lambda_init = LAMBDA_INIT_BASE - LAMBDA_INIT_AMP * math.exp(-LAMBDA_INIT_RATE * l)
        lam = (jnp.exp(jnp.sum(lambda_q1[l].astype(jnp.float32) * lambda_k1[l].astype(jnp.float32)))
               - jnp.exp(jnp.sum(lambda_q2[l].astype(jnp.float32) * lambda_k2[l].astype(jnp.float32)))
               + lambda_init)
        y_b = diff_attention(q, k, v, rel_bias, lam, lambda_init, subln_g[l]) @ w_b_proj[l]

        gates = jax.nn.sigmoid((xn @ w_gate[l] + b_gate[l]).astype(jnp.float32)).astype(h.dtype)
        g_a, g_b = gates[..., :D_MODEL], gates[..., D_MODEL:]
        h = h + (g_a * y_a + g_b * y_b) @ w_out[l]

        h = h + cross_attention(rmsnorm(h, norm_cross_g[l]), rmsnorm(mem, norm_mem_g[l]),
                                w_cq[l], w_ckv[l], w_co[l])

        hn = rmsnorm(h, norm_mlp_g[l])
        h = h + jnp.square(jax.nn.relu(hn @ w_ff1[l])) @ w_ff2[l]
    return rmsnorm(h, final_norm_g)
```

```cpp
#include <hip/hip_runtime.h>
#include <cstdio>
#include <cstdint>

typedef unsigned short bf16_t;
constexpr int M = 16384, D = 1024, SEQ = 2048, NB = 8, MEMT = 2048, FF = 4096;
constexpr float EPS = 1e-6f;
constexpr float LOG2E = 1.4426950408889634f;
constexpr float C2 = 0.125f * LOG2E;
constexpr float CX = 0.0625f * LOG2E;
constexpr int TABN = 768, TABOFF = 703;

constexpr size_t MiB = 1u << 20;
constexpr size_t WS_CTL = 0, WS_TAB = MiB / 2, WS_LAM = MiB / 2 + 32768, WS_WG = 1 * MiB, WS_XSLOT = 3 * MiB / 2;
constexpr size_t WS_WIN = 2 * MiB, WS_WGATE = 10 * MiB, WS_WCKV = 14 * MiB, WS_WA = 18 * MiB, WS_CK = 20 * MiB, WS_CVT = 24 * MiB;
constexpr size_t S1 = 32 * MiB, S2 = 64 * MiB, S3 = 96 * MiB, S4 = 128 * MiB, S5 = 160 * MiB, S6 = 192 * MiB, S7 = 224 * MiB, WS_END = 256 * MiB;
constexpr size_t WS_XN = S1, WS_U = S2, WS_Q = S3, WS_K = S4, WS_V = S5, WS_GA = S6, WS_GB = S7;
constexpr size_t WS_YA = S1, WS_OB = S2, WS_MR = S4, WS_HN2 = S1, WS_CQ = S2, WS_SC = S4, WS_P = S6, WS_COATT = S7, WS_HN3 = S1, WS_FFH = S4;
constexpr size_t WS_WFF1 = S3, WS_WFF2 = S3 + 8 * MiB, WS_WB = S3 + 16 * MiB, WS_WOUT = S3 + 18 * MiB, WS_WCQ = S3 + 20 * MiB, WS_WCO = S3 + 22 * MiB;

__device__ __forceinline__ unsigned f2bf(float f) { unsigned u = __builtin_bit_cast(unsigned, f); return (u + 0x7fffu + ((u >> 16) & 1u)) >> 16; }
__device__ __forceinline__ float bf2f(bf16_t h) { return __builtin_bit_cast(float, (unsigned)h << 16); }

__global__ void __launch_bounds__(256) k_transpose(const float* __restrict__ W, int K, int N, bf16_t* __restrict__ WT, int ldo) {
    __shared__ float t[32][33];
    const int n0 = blockIdx.x * 32, k0 = blockIdx.y * 32, tx = threadIdx.x & 31, ty = threadIdx.x >> 5;
    for (int i = ty; i < 32; i += 8) t[i][tx] = W[(size_t)(k0 + i) * N + n0 + tx];
    __syncthreads();
    for (int i = ty; i < 32; i += 8) WT[(size_t)(n0 + i) * ldo + k0 + tx] = (bf16_t)f2bf(t[tx][i]);
}
__global__ void __launch_bounds__(256) k_rmsnorm_bf16(const float* __restrict__ x, const float* __restrict__ g, bf16_t* __restrict__ out, int rows) {
    const int row = blockIdx.x * 4 + (threadIdx.x >> 6), lane = threadIdx.x & 63; if (row >= rows) return;
    const float* xr = x + (size_t)row * D; float v[16]; float s = 0.f;
#pragma unroll
    for (int j = 0; j < 16; ++j) { v[j] = xr[lane + 64 * j]; s += v[j] * v[j]; }
#pragma unroll
    for (int o = 1; o < 64; o <<= 1) s += __shfl_xor(s, o);
    const float rs = 1.0f / sqrtf(s * (1.0f / D) + EPS);
#pragma unroll
    for (int j = 0; j < 16; ++j) out[(size_t)row * D + lane + 64 * j] = (bf16_t)f2bf(v[j] * rs * g[lane + 64 * j]);
}
__global__ void __launch_bounds__(256) k_rmsnorm_f32(const float* x, const float* __restrict__ g, float* out, int rows) {
    const int row = blockIdx.x * 4 + (threadIdx.x >> 6), lane = threadIdx.x & 63; if (row >= rows) return;
    const float* xr = x + (size_t)row * D; float v[16]; float s = 0.f;
#pragma unroll
    for (int j = 0; j < 16; ++j) { v[j] = xr[lane + 64 * j]; s += v[j] * v[j]; }
#pragma unroll
    for (int o = 1; o < 64; o <<= 1) s += __shfl_xor(s, o);
    const float rs = 1.0f / sqrtf(s * (1.0f / D) + EPS);
#pragma unroll
    for (int j = 0; j < 16; ++j) out[(size_t)row * D + lane + 64 * j] = v[j] * rs * g[lane + 64 * j];
}
__device__ __forceinline__ int t5_bucket(int rel) {
    const int n = rel < 0 ? -rel : rel; int b;
    if (n < 8) b = n; else if (n < 12) b = 8; else if (n < 16) b = 9; else if (n < 23) b = 10; else if (n < 32) b = 11; else if (n < 46) b = 12; else if (n < 64) b = 13; else if (n < 91) b = 14; else b = 15;
    return (rel > 0 ? 16 : 0) + b;
}
__global__ void __launch_bounds__(256) k_tab(const float* __restrict__ rel_bias, const float* lq1, const float* lk1, const float* lq2, const float* lk2, float* tab, float* lam) {
    const int i = blockIdx.x * 256 + threadIdx.x;
    if (i < 8 * TABN) { const int h = i / TABN, r = i % TABN - TABOFF; tab[i] = (rel_bias[t5_bucket(r) * 8 + h] - rel_bias[15 * 8 + h]) * LOG2E; }
    if (i == 0) { float a = 0.f, b = 0.f; for (int d = 0; d < 64; ++d) { a += lq1[d] * lk1[d]; b += lq2[d] * lk2[d]; } lam[0] = expf(a) - expf(b) + 0.2f; }
}

template <class E>
__global__ void __launch_bounds__(256) k_ngemm(E e, int K) {
    __shared__ float As[16][68], Bs[16][68];
    const int z = blockIdx.z; const bf16_t* A = e.A(z); const bf16_t* B = e.B(z); const int lda = e.lda, ldb = e.ldb;
    const int tx = threadIdx.x & 15, ty = threadIdx.x >> 4, m0 = blockIdx.y * 64, n0 = blockIdx.x * 64;
    const int r = threadIdx.x >> 2, kq = (threadIdx.x & 3) * 4;
    float acc[4][4];
#pragma unroll
    for (int i = 0; i < 4; ++i)
#pragma unroll
        for (int j = 0; j < 4; ++j) acc[i][j] = 0.f;
    for (int k0 = 0; k0 < K; k0 += 16) {
        const uint2 av = *(const uint2*)(A + (size_t)(m0 + r) * lda + k0 + kq), bv = *(const uint2*)(B + (size_t)(n0 + r) * ldb + k0 + kq);
        As[kq + 0][r] = bf2f((bf16_t)(av.x & 0xffff)); As[kq + 1][r] = bf2f((bf16_t)(av.x >> 16)); As[kq + 2][r] = bf2f((bf16_t)(av.y & 0xffff)); As[kq + 3][r] = bf2f((bf16_t)(av.y >> 16));
        Bs[kq + 0][r] = bf2f((bf16_t)(bv.x & 0xffff)); Bs[kq + 1][r] = bf2f((bf16_t)(bv.x >> 16)); Bs[kq + 2][r] = bf2f((bf16_t)(bv.y & 0xffff)); Bs[kq + 3][r] = bf2f((bf16_t)(bv.y >> 16));
        __syncthreads();
#pragma unroll
        for (int kk = 0; kk < 16; ++kk) { float a[4], b[4];
#pragma unroll
            for (int i = 0; i < 4; ++i) { a[i] = As[kk][ty * 4 + i]; b[i] = Bs[kk][tx * 4 + i]; }
#pragma unroll
            for (int i = 0; i < 4; ++i)
#pragma unroll
                for (int j = 0; j < 4; ++j) acc[i][j] += a[i] * b[j]; }
        __syncthreads();
    }
#pragma unroll
    for (int i = 0; i < 4; ++i)
#pragma unroll
        for (int j = 0; j < 4; ++j) e(z, m0 + ty * 4 + i, n0 + tx * 4 + j, acc[i][j]);
}
struct EBase { const bf16_t* a; const bf16_t* b; int lda, ldb;
    __device__ const bf16_t* A(int) const { return a; } __device__ const bf16_t* B(int) const { return b; } };
struct EProj : EBase { bf16_t* U; const float* bgate;
    __device__ void operator()(int, int m, int n, float v) const { const int t = n >> 10, c = n & 1023;
        if (t == 1) v *= C2; else if (t >= 4) { v += bgate[n - 4096]; v = 1.0f / (1.0f + __expf(-v)); }
        U[(size_t)t * ((size_t)M * D) + (size_t)m * D + c] = (bf16_t)f2bf(v); } };
struct ECkv : EBase { bf16_t* CK; bf16_t* CVT;
    __device__ void operator()(int, int m, int n, float v) const {
        if (n < 1024) CK[(size_t)m * 1024 + n]= (bf16_t)f2bf(v); else { const int b = m >> 8, key = m & 255; CVT[((size_t)b * 1024 + (n - 1024)) * 256 + key] = (bf16_t)f2bf(v); } } };
struct EPoolG : EBase { bf16_t* YA; const float* scale;
    __device__ const bf16_t* A(int z) const { return a + z * 256; } __device__ const bf16_t* B(int z) const { return b + (size_t)z * 65536; }
    __device__ void operator()(int z, int m, int n, float v) const { YA[(size_t)m * D + z * 256 + n] = (bf16_t)f2bf(v * scale[z * 256 + n]); } };
struct EMergeA : EBase { float* TMP; const bf16_t* GA;
    __device__ void operator()(int, int m, int n, float v) const { TMP[(size_t)m * D + n] = bf2f(GA[(size_t)m * D + n]) * v; } };
struct EMergeB : EBase { const float* TMP; const bf16_t* GB; bf16_t* MR;
    __device__ void operator()(int, int m, int n, float v) const { MR[(size_t)m * D + n] = (bf16_t)f2bf(TMP[(size_t)m * D + n] + bf2f(GB[(size_t)m * D + n]) * v); } };
struct EResid : EBase { const float* base; float* out;
    __device__ void operator()(int, int m, int n, float v) const { out[(size_t)m * D + n] = base[(size_t)m * D + n] + v; } };
struct EScaleBf : EBase { bf16_t* O; int ldo; float s;
    __device__ void operator()(int, int m, int n, float v) const { O[(size_t)m * ldo + n] = (bf16_t)f2bf(v * s); } };
struct ECrossS : EBase { float* SC;
    __device__ const bf16_t* A(int z) const { return a + (size_t)(z >> 2) * 2048 * 1024 + (z & 3) * 256; } __device__ const bf16_t* B(int z) const { return b + (size_t)(z >> 2) * 256 * 1024 + (z & 3) * 256; }
    __device__ void operator()(int z, int m, int n, float v) const { SC[((size_t)(z >> 2) * 2048 + m) * 1024 + (z & 3) * 256 + n] = v; } };
struct ECrossPV : EBase { bf16_t* O;
    __device__ const bf16_t* A(int z) const { return a + (size_t)(z >> 2) * 2048 * 1024 + (z & 3) * 256; } __device__ const bf16_t* B(int z) const { return b + ((size_t)(z >> 2) * 1024 + (z & 3) * 256) * 256; }
    __device__ void operator()(int z, int m, int n, float v) const { O[((size_t)(z >> 2) * 2048 + m) * 1024 + (z & 3) * 256 + n] = (bf16_t)f2bf(v); } };
struct ERelu2 : EBase { bf16_t* O;
    __device__ void operator()(int, int m, int n, float v) const { v = v > 0.f ? v * v : 0.f; O[(size_t)m * FF + n] = (bf16_t)f2bf(v); } };

__global__ void __launch_bounds__(256) k_pool(const bf16_t* __restrict__ U, bf16_t* __restrict__ PB) {
    const int idx = blockIdx.x * 256 + threadIdx.x, row = idx >> 10, col = idx & 1023, g = col >> 8, w = 2 << g, t = row & (SEQ - 1);
    const int cnt = (t + 1) < w ? (t + 1) : w; float s = 0.f;
    for (int i = 0; i < cnt; ++i) s += bf2f(U[(size_t)(row - i) * D + col]);
    PB[idx] = (bf16_t)f2bf(s / (float)cnt - bf2f(U[idx]));
}
__global__ void __launch_bounds__(64) k_nattn(const bf16_t* __restrict__ Q, const bf16_t* __restrict__ Kb, const bf16_t* __restrict__ Vb, bf16_t* O0, bf16_t* O1, const float* __restrict__ tab) {
    const int row = blockIdx.x * 64 + threadIdx.x, b = row >> 11, t = row & (SEQ - 1);
    const int vh = blockIdx.y >> 2, qt = blockIdx.y & 3, h = vh >> 1, m = vh & 1;
    float q[64];
#pragma unroll
    for (int d = 0; d < 64; ++d) q[d] = bf2f(Q[(size_t)row * D + vh * 64 + d]);
    const int kend = ((t >> 6) + 1) << 6;
    float mx = -1e30f, l = 0.f, o[32];
#pragma unroll
    for (int e = 0; e < 32; ++e) o[e] = 0.f;
    const float* tb = tab + h * TABN;
    for (int j = 0; j < kend; ++j) {
        const bf16_t* kr = Kb + (size_t)(b * SEQ + j) * D + vh * 64; float s = 0.f;
#pragma unroll
        for (int d = 0; d < 64; ++d) s += q[d] * bf2f(kr[d]);
        const int rel = j - t; if (rel >= -TABOFF) s += tb[rel + TABOFF];
        const float mn = fmaxf(mx, s), al = exp2f(mx - mn), p = exp2f(s - mn);
        l = l * al + p; const bf16_t* vr = Vb + (size_t)(b * SEQ + j) * D + h * 128 + qt * 32;
#pragma unroll
        for (int e = 0; e < 32; ++e) o[e] = o[e] * al + p * bf2f(vr[e]);
        mx = mn;
    }
    bf16_t* O = m ? O1 : O0; const float il = 1.0f / l;
#pragma unroll
    for (int e = 0; e < 32; ++e) O[(size_t)row * D + h * 128 + qt * 32 + e] = (bf16_t)f2bf(o[e] * il);
}
__global__ void __launch_bounds__(256) k_combine(const bf16_t* __restrict__ O0, const bf16_t* __restrict__ O1, const float* __restrict__ lam, const float* __restrict__ sg, bf16_t* __restrict__ OB) {
    const int idx = blockIdx.x * 256 + threadIdx.x, row = idx >> 3, h = idx & 7; const float lm = lam[0];
    const size_t base = (size_t)row * D + h * 128; float ss = 0.f;
    for (int e = 0; e < 128; ++e) { const float d = bf2f(O0[base + e]) - lm * bf2f(O1[base + e]); ss += d * d; }
    const float rs = 1.0f / sqrtf(ss * (1.0f / 128.0f) + EPS);
    for (int e = 0; e < 128; ++e) { const float d = bf2f(O0[base + e]) - lm * bf2f(O1[base + e]); OB[base + e] = (bf16_t)f2bf(d * rs * sg[e] * 0.8f); }
}
__global__ void __launch_bounds__(256) k_softmax256(const float* __restrict__ SC, bf16_t* __restrict__ P) {
    const int idx = blockIdx.x * 256 + threadIdx.x; const size_t base = (size_t)idx * 256;
    float mx = -1e30f; for (int j = 0; j < 256; ++j) mx = fmaxf(mx, SC[base + j]);
    float l = 0.f; for (int j = 0; j < 256; ++j) l += exp2f(SC[base + j] - mx);
    const float il = 1.0f / l; for (int j = 0; j < 256; ++j) P[base + j] = (bf16_t)f2bf(exp2f(SC[base + j] - mx) * il);
}

template <class E> static void ngemm(hipStream_t st, const E& e, int Mr, int N, int K, int Z = 1) { hipLaunchKernelGGL(k_ngemm<E>, dim3(N / 64, Mr / 64, Z), dim3(256), 0, st, e, K); }
static void transpose(hipStream_t st, const float* W, int K, int N, bf16_t* WT, int ldo) { hipLaunchKernelGGL(k_transpose, dim3(N / 32, K / 32), dim3(256), 0, st, W, K, N, WT, ldo); }

extern "C" void kernel_launch(void* const* d_in, const int* in_sizes, int n_in, void* d_out, int out_size, void* d_ws, size_t ws_size, hipStream_t stream) {
    if (n_in != 26 || in_sizes[0] != M * D || out_size != M * D || ws_size < WS_END) { fprintf(stderr, "kernel_launch: unexpected shapes (n_in %d, in0 %d, out %d, ws %zu)\n", n_in, n_in > 0 ? in_sizes[0] : -1, out_size, ws_size); return; }
    const float* x = (const float*)d_in[0]; const float* mem = (const float*)d_in[1]; const float* norm_mix_g = (const float*)d_in[2]; const float* w_in = (const float*)d_in[3];
    const float* w_pool_group = (const float*)d_in[4]; const float* pool_scale = (const float*)d_in[5]; const float* w_a_proj = (const float*)d_in[6];
    const float* lq1 = (const float*)d_in[7]; const float* lk1 = (const float*)d_in[8]; const float* lq2 = (const float*)d_in[9]; const float* lk2 = (const float*)d_in[10];
    const float* subln_g = (const float*)d_in[11]; const float* rel_bias = (const float*)d_in[12]; const float* w_b_proj = (const float*)d_in[13]; const float* w_gate = (const float*)d_in[14];
    const float* b_gate = (const float*)d_in[15]; const float* w_out = (const float*)d_in[16]; const float* norm_cross_g = (const float*)d_in[17]; const float* norm_mem_g = (const float*)d_in[18];
    const float* w_cq = (const float*)d_in[19]; const float* w_ckv = (const float*)d_in[20]; const float* w_co = (const float*)d_in[21]; const float* norm_mlp_g = (const float*)d_in[22];
    const float* w_ff1 = (const float*)d_in[23]; const float* w_ff2 = (const float*)d_in[24]; const float* final_norm_g = (const float*)d_in[25];
    unsigned char* ws = (unsigned char*)d_ws; float* out = (float*)d_out;
#define WSB(off) ((bf16_t*)(ws + (off)))
    bf16_t* MN = (bf16_t*)((unsigned char*)d_out + 32 * MiB); bf16_t* PB = (bf16_t*)d_out; bf16_t* O0 = (bf16_t*)d_out; bf16_t* O1 = (bf16_t*)((unsigned char*)d_out + 32 * MiB);
    float* tab = (float*)(ws + WS_TAB); float* lam = (float*)(ws + WS_LAM);
    transpose(stream, w_in, D, 4096, WSB(WS_WIN), D); transpose(stream, w_gate, D, 2048, WSB(WS_WGATE), D); transpose(stream, w_ckv, D, 2048, WSB(WS_WCKV), D);
    transpose(stream, w_a_proj, D, D, WSB(WS_WA), D);
    for (int g = 0; g < 4; ++g) transpose(stream, w_pool_group + (size_t)g * 65536, 256, 256, WSB(WS_WG) + (size_t)g * 65536, 256);
    hipLaunchKernelGGL(k_rmsnorm_bf16, dim3(M / 4), dim3(256), 0, stream, x, norm_mix_g, WSB(WS_XN), M);
    hipLaunchKernelGGL(k_rmsnorm_bf16, dim3(MEMT / 4), dim3(256), 0, stream, mem, norm_mem_g, MN, MEMT);
    hipLaunchKernelGGL(k_tab, dim3(8 * TABN / 256), dim3(256), 0, stream, rel_bias, lq1, lk1, lq2, lk2, tab, lam);
    { EProj e; e.a = WSB(WS_XN); e.b = WSB(WS_WIN); e.lda = D; e.ldb = D; e.U = WSB(WS_U); e.bgate = b_gate; ngemm(stream, e, M, 6144, D); }
    { ECkv e; e.a = MN; e.b = WSB(WS_WCKV); e.lda = D; e.ldb = D; e.CK = WSB(WS_CK); e.CVT = WSB(WS_CVT); ngemm(stream, e, MEMT, 2048, D); }
    hipLaunchKernelGGL(k_pool, dim3(M * D / 256), dim3(256), 0, stream, WSB(WS_U), PB);
    { EPoolG e; e.a = PB; e.b = WSB(WS_WG); e.lda = D; e.ldb = 256; e.YA = WSB(WS_YA); e.scale = pool_scale; ngemm(stream, e, M, 256, 256, 4); }
    hipLaunchKernelGGL(k_nattn, dim3(M / 64, 64), dim3(64), 0, stream, WSB(WS_Q), WSB(WS_K), WSB(WS_V), O0, O1, tab);
    hipLaunchKernelGGL(k_combine, dim3(M * 8 / 256), dim3(256), 0, stream, O0, O1, lam, subln_g, WSB(WS_OB));
    transpose(stream, w_ff1, D, FF, WSB(WS_WFF1), D); transpose(stream, w_ff2, FF, D, WSB(WS_WFF2), FF); transpose(stream, w_b_proj, D, D, WSB(WS_WB), D);
    transpose(stream, w_out, D, D, WSB(WS_WOUT), D); transpose(stream, w_cq, D, D, WSB(WS_WCQ), D); transpose(stream, w_co, D, D, WSB(WS_WCO), D);
    { EMergeA e; e.a = WSB(WS_YA); e.b = WSB(WS_WA); e.lda = D; e.ldb = D; e.TMP = out; e.GA = WSB(WS_GA); ngemm(stream, e, M, D, D); }
    { EMergeB e; e.a = WSB(WS_OB); e.b = WSB(WS_WB); e.lda = D; e.ldb = D; e.TMP = out; e.GB = WSB(WS_GB); e.MR = WSB(WS_MR); ngemm(stream, e, M, D, D); }
    { EResid e; e.a = WSB(WS_MR); e.b = WSB(WS_WOUT); e.lda = D; e.ldb = D; e.base = x; e.out = out; ngemm(stream, e, M, D, D); }
    hipLaunchKernelGGL(k_rmsnorm_bf16, dim3(M / 4), dim3(256), 0, stream, out, norm_cross_g, WSB(WS_HN2), M);
    { EScaleBf e; e.a = WSB(WS_HN2); e.b = WSB(WS_WCQ); e.lda = D; e.ldb = D; e.O = WSB(WS_CQ); e.ldo = D; e.s = CX; ngemm(stream, e, M, D, D); }
    { ECrossS e; e.a = WSB(WS_CQ); e.b = WSB(WS_CK); e.lda = D; e.ldb = D; e.SC = (float*)(ws + WS_SC); ngemm(stream, e, 2048, 256, 256, 32); }
    hipLaunchKernelGGL(k_softmax256, dim3(M * 4 / 256), dim3(256), 0, stream, (const float*)(ws + WS_SC), WSB(WS_P));
    { ECrossPV e; e.a = WSB(WS_P); e.b = WSB(WS_CVT); e.lda = D; e.ldb = 256; e.O = WSB(WS_COATT); ngemm(stream, e, 2048, 256, 256, 32); }
    { EResid e; e.a = WSB(WS_COATT); e.b = WSB(WS_WCO); e.lda = D; e.ldb = D; e.base = out; e.out = out; ngemm(stream, e, M, D, D); }
    hipLaunchKernelGGL(k_rmsnorm_bf16, dim3(M / 4), dim3(256), 0, stream, out, norm_mlp_g, WSB(WS_HN3), M);
    { ERelu2 e; e.a = WSB(WS_HN3); e.b = WSB(WS_WFF1); e.lda = D; e.ldb = D; e.O = WSB(WS_FFH); ngemm(stream, e, M, FF, D); }
    { EResid e; e.a = WSB(WS_FFH); e.b = WSB(WS_WFF2); e.lda = FF; e.ldb = FF; e.base = out; e.out = out; ngemm(stream, e, M, D, FF); }
    hipLaunchKernelGGL(k_rmsnorm_f32, dim3(M / 4), dim3(256), 0, stream, out, final_norm_g, out, M);
#undef WSB
}
```
